# Optimizing an MI355X kernel written in HIP

```python
import math
import jax, jax.numpy as jnp
from jax import lax
import numpy as np

D_MODEL = 1024
BATCH = 2
SEQ = 8192
DEPTH = 4

HEAD_DIM = 64
N_HEADS_PER_MIXER = 4
GROUP_WIDTH = N_HEADS_PER_MIXER * HEAD_DIM
N_MIXERS = 4
MIX_WIDTH = N_MIXERS * GROUP_WIDTH
DIFF_QK_DIM = HEAD_DIM // 2
Q_BLOCK = 128
SGU_CHUNK = 128
DILATED_PATTERNS = ((128, 1), (512, 4), (2048, 16))
DIL_BLOCK = 128
MLSTM_CHUNK = 128
CONV_WIDTH = 4
ROPE_THETA = 500000.0
ROT_FRACTION = 4
D_FF = -(-8 * D_MODEL // (3 * 256)) * 256
ALPHA = (2 * DEPTH) ** 0.25
BETA = (8 * DEPTH) ** -0.25
LN_EPS = 1e-5
SPLIT_SIZES = (GROUP_WIDTH,) * 3 + (GROUP_WIDTH,) * 2 + (GROUP_WIDTH,) * 3 + (GROUP_WIDTH,) * 4 + (N_HEADS_PER_MIXER, N_HEADS_PER_MIXER)
IN_WIDTH = sum(SPLIT_SIZES)
SPLIT_IDX = tuple(int(v) for v in np.cumsum(SPLIT_SIZES)[:-1])

kernel_name = "hymba_style_diff_sgu_dilated_mlstm"


def layer_norm(x, g, b):
    xf = x.astype(jnp.float32)
    mu = xf.mean(-1, keepdims=True)
    var = jnp.square(xf - mu).mean(-1, keepdims=True)
    return ((xf - mu) * lax.rsqrt(var + LN_EPS) * g + b).astype(x.dtype)


def rms_norm(x, g):
    xf = x.astype(jnp.float32)
    return (xf * lax.rsqrt(jnp.square(xf).mean(-1, keepdims=True) + LN_EPS) * g).astype(x.dtype)


def rope_tables(seq, head_dim):
    rot = head_dim // ROT_FRACTION
    pos = jnp.arange(seq, dtype=jnp.float32)
    inv = ROPE_THETA ** (-jnp.arange(0, rot, 2, dtype=jnp.float32) / rot)
    ang = pos[:, None] * inv[None, :]
    return jnp.cos(ang), jnp.sin(ang)


def partial_rope(x, cos, sin):
    half = cos.shape[-1]
    x1, x2, xp = x[..., :half], x[..., half:2 * half], x[..., 2 * half:]
    c = cos[None, :, None, :].astype(x.dtype)
    s = sin[None, :, None, :].astype(x.dtype)
    return jnp.concatenate([x1 * c - x2 * s, x2 * c + x1 * s, xp], axis=-1)


def diff_attention(q, k, v, lam):
    B, S, H, _, Dk = q.shape
    nq = S // Q_BLOCK
    scale = Dk ** -0.5
    qb = jnp.moveaxis(q.reshape(B, nq, Q_BLOCK, H, 2, Dk), 1, 0)
    kpos = jnp.arange(S)

    def block(args):
        qi, idx = args
        s = jnp.einsum('bqhmd,bkhmd->bhmqk', qi, k).astype(jnp.float32) * scale
        qpos = idx * Q_BLOCK + jnp.arange(Q_BLOCK)
        s = jnp.where((kpos[None, :] <= qpos[:, None])[None, None, None], s, -jnp.inf)
        p = jax.nn.softmax(s, axis=-1)
        a = p[:, :, 0] - lam * p[:, :, 1]
        return jnp.einsum('bhqk,bkhd->bqhd', a.astype(v.dtype), v)

    o = lax.map(block, (qb, jnp.arange(nq)))
    return jnp.moveaxis(o, 0, 1).reshape(B, S, H, v.shape[-1])


def spatial_gating(u, v, ln_g, ln_b, w_s, b_s):
    B, S, W = v.shape
    G, C, _ = w_s.shape
    nc = S // C
    u = jax.nn.gelu(u)
    v = layer_norm(jax.nn.gelu(v), ln_g, ln_b)
    vc = v.reshape(B, nc, C, G, W // G)
    w = w_s * jnp.tril(jnp.ones((C, C), w_s.dtype))[None]
    z = jnp.einsum('gts,bnsgd->bntgd', w, vc) + jnp.transpose(b_s)[None, None, :, :, None]
    return u * z.reshape(B, S, W)


def dilated_pattern(q, k, v, window, dilation):
    B, S, H, D = q.shape
    I = DIL_BLOCK
    span = dilation * I
    s_pad = -(-S // span) * span
    nb = s_pad // span

    def to_blocks(t):
        t = jnp.pad(t, ((0, 0), (0, s_pad - S), (0, 0), (0, 0)))
        return t.reshape(B, nb, I, dilation, H, D)

    def with_prev(t):
        prev = jnp.pad(t[:, :-1], ((0, 0), (1, 0), (0, 0), (0, 0), (0, 0), (0, 0)))
        return jnp.concatenate([prev, t], axis=2)

    qb = to_blocks(q)
    kk, vv = with_prev(to_blocks(k)), with_prev(to_blocks(v))
    s = jnp.einsum('bnirhd,bnjrhd->bnrhij', qb, kk).astype(jnp.float32)
    i_idx = jnp.arange(I)[:, None]
    j_idx = jnp.arange(2 * I)[None, :]
    dist = I + i_idx - j_idx
    band = (dist >= 0) & (dist <= window // dilation)
    start_ok = (jnp.arange(nb)[:, None, None] * I + j_idx[None] - I) >= 0
    valid = band[None] & start_ok
    s = jnp.where(valid[None, :, None, None], s, -jnp.inf)
    m = s.max(-1, keepdims=True)
    p = jnp.exp(s - m)
    den = p.sum(-1, keepdims=True)
    o = jnp.einsum('bnrhij,bnjrhd->bnirhd', (p / den).astype(v.dtype), vv)
    lse = (m + jnp.log(den))[..., 0]
    o = o.reshape(B, s_pad, H, D)[:, :S]
    lse = jnp.transpose(lse, (0, 1, 4, 2, 3)).reshape(B, s_pad, H)[:, :S]
    return o, lse


def dilated_mixture(q, k, v):
    outs, lses = [], []
    for window, dilation in DILATED_PATTERNS:
        o, l = dilated_pattern(q, k, v, window, dilation)
        outs.append(o)
        lses.append(l)
    wts = jax.nn.softmax(jnp.stack(lses, 0), axis=0)
    return jnp.einsum('pbsh,pbshd->bshd', wts.astype(q.dtype), jnp.stack(outs, 0))


def causal_depthwise_conv(x, w, b):
    K, C = w.shape
    y = lax.conv_general_dilated(x, w[:, None, :], window_strides=(1,), padding=[(K - 1, 0)],
                                 dimension_numbers=('NWC', 'WIO', 'NWC'), feature_group_count=C)
    return y + b


def mlstm_chunkwise(q, k, v, i_pre, f_pre):
    B, S, H, D = q.shape
    L = MLSTM_CHUNK
    nc = S // L
    f32 = jnp.float32
    qc = q.astype(f32).reshape(B, nc, L, H, D)
    kc = (k.astype(f32) * D ** -0.5).reshape(B, nc, L, H, D)
    vc = v.astype(f32).reshape(B, nc, L, H, D)
    ic = i_pre.astype(f32).reshape(B, nc, L, H)
    b = jnp.cumsum(jax.nn.log_sigmoid(f_pre.astype(f32)).reshape(B, nc, L, H), axis=2)
    b_last = b[:, :, -1]
    causal = jnp.tril(jnp.ones((L, L), bool))
    d_log = jnp.where(causal[None, None, :, :, None],
                      b[:, :, :, None] - b[:, :, None] + ic[:, :, None], -jnp.inf)
    g = b_last[:, :, None] - b + ic
    g_max = g.max(axis=2)
    w = jnp.exp(g - g_max[:, :, None])
    c_loc = jnp.einsum('bnsh,bnshd,bnshe->bnhde', w, vc, kc)
    n_loc = jnp.einsum('bnsh,bnshe->bnhe', w, kc)

    def step(carry, xs):
        c, n, m = carry
        cl, nl, gm, bl = xs
        m_new = jnp.maximum(bl + m, gm)
        a = jnp.exp(bl + m - m_new)
        e = jnp.exp(gm - m_new)
        return (a[..., None, None] * c + e[..., None, None] * cl,
                a[..., None] * n + e[..., None] * nl, m_new), (c, n, m)

    init = (jnp.zeros((B, H, D, D), f32), jnp.zeros((B, H, D), f32), jnp.zeros((B, H), f32))
    sw_ax = lambda t: jnp.moveaxis(t, 1, 0)
    _, (c_prev, n_prev, m_prev) = lax.scan(step, init, (sw_ax(c_loc), sw_ax(n_loc), sw_ax(g_max), sw_ax(b_last)))
    c_prev, n_prev, m_prev = sw_ax(c_prev), sw_ax(n_prev), sw_ax(m_prev)
    inter_log = b + m_prev[:, :, None]
    m_out = jnp.maximum(inter_log, d_log.max(axis=3))
    p = jnp.exp(d_log - m_out[:, :, :, None])
    sw = p * jnp.einsum('bnthd,bnshd->bntsh', qc, kc)
    e = jnp.exp(inter_log - m_out)
    num = jnp.einsum('bntsh,bnshd->bnthd', sw, vc) + e[..., None] * jnp.einsum('bnhde,bnthe->bnthd', c_prev, qc)
    den = sw.sum(axis=3) + e * jnp.einsum('bnhe,bnthe->bnth', n_prev, qc)
    h = num / jnp.maximum(jnp.abs(den), jnp.exp(-m_out))[..., None]
    return h.reshape(B, S, H, D)


def mixer_block(x, w_in, lam_vecs, lam_init, subln_g, sgu_ln_g, sgu_ln_b, sgu_w, sgu_b,
                conv_w, conv_b, gate_b, mnorm_g, w_out, rope_a, rope_c):
    B, S, _ = x.shape
    H = N_HEADS_PER_MIXER
    z = jnp.einsum('bsd,df->bsf', x, w_in)
    (a_q, a_k, a_v, b_u, b_v, c_q, c_k, c_v,
     d_q, d_k, d_v, d_o, d_i, d_f) = jnp.split(z, SPLIT_IDX, axis=-1)

    aq = partial_rope(a_q.reshape(B, S, 2 * H, DIFF_QK_DIM), *rope_a).reshape(B, S, H, 2, DIFF_QK_DIM)
    ak = partial_rope(a_k.reshape(B, S, 2 * H, DIFF_QK_DIM), *rope_a).reshape(B, S, H, 2, DIFF_QK_DIM)
    lv = lam_vecs.astype(jnp.float32)
    lam = jnp.exp(jnp.sum(lv[0] * lv[1])) - jnp.exp(jnp.sum(lv[2] * lv[3])) + lam_init
    out_a = diff_attention(aq, ak, a_v.reshape(B, S, H, HEAD_DIM), lam)
    out_a = rms_norm(out_a, subln_g) * (1.0 - lam_init)

    out_b = spatial_gating(b_u, b_v, sgu_ln_g, sgu_ln_b, sgu_w, sgu_b)

    cq = partial_rope(c_q.reshape(B, S, H, HEAD_DIM), *rope_c) * HEAD_DIM ** -0.5
    ck = partial_rope(c_k.reshape(B, S, H, HEAD_DIM), *rope_c)
    out_c = dilated_mixture(cq, ck, c_v.reshape(B, S, H, HEAD_DIM))

    qk = jax.nn.silu(causal_depthwise_conv(jnp.concatenate([d_q, d_k], -1), conv_w, conv_b))
    mq, mk = qk[..., :GROUP_WIDTH], qk[..., GROUP_WIDTH:]
    h = mlstm_chunkwise(mq.reshape(B, S, H, HEAD_DIM), mk.reshape(B, S, H, HEAD_DIM),
                        d_v.reshape(B, S, H, HEAD_DIM), d_i + gate_b[0], d_f + gate_b[1])
    h = layer_norm(h, mnorm_g, 0.0).astype(x.dtype)
    out_d = jax.nn.sigmoid(d_o.reshape(B, S, H, HEAD_DIM)) * h

    mixed = jnp.concatenate([out_a.reshape(B, S, GROUP_WIDTH).astype(x.dtype), out_b.astype(x.dtype),
                             out_c.reshape(B, S, GROUP_WIDTH).astype(x.dtype),
                             out_d.reshape(B, S, GROUP_WIDTH).astype(x.dtype)], axis=-1)
    return jnp.einsum('bsf,fd->bsd', mixed, w_out)


def swiglu(x, w_gate, w_up, w_down):
    g = jnp.einsum('bsd,df->bsf', x, w_gate)
    u = jnp.einsum('bsd,df->bsf', x, w_up)
    return jnp.einsum('bsf,fd->bsd', jax.nn.silu(g) * u, w_down)


def setup_inputs(seed: int = 0) -> dict:
    key = jax.random.key(seed)
    ks = jax.random.split(key, 24)
    L, H = DEPTH, N_HEADS_PER_MIXER
    nrm = lambda k, shape, scale: jax.random.normal(k, shape, jnp.float32) * scale
    return {
        "x": nrm(ks[0], (BATCH, SEQ, D_MODEL), 1.0),
        "w_in": nrm(ks[1], (L, D_MODEL, IN_WIDTH), D_MODEL ** -0.5),
        "diff_lambda": nrm(ks[2], (L, 4, DIFF_QK_DIM), 0.1),
        "diff_subln_g": 1.0 + nrm(ks[3], (L, HEAD_DIM), 0.02),
        "sgu_ln_g": 1.0 + nrm(ks[4], (L, GROUP_WIDTH), 0.02),
        "sgu_ln_b": nrm(ks[5], (L, GROUP_WIDTH), 0.02),
        "sgu_w": nrm(ks[6], (L, H, SGU_CHUNK, SGU_CHUNK), SGU_CHUNK ** -0.5),
        "sgu_b": 1.0 + nrm(ks[7], (L, H, SGU_CHUNK), 0.02),
        "mlstm_conv_w": nrm(ks[8], (L, CONV_WIDTH, 2 * GROUP_WIDTH), CONV_WIDTH ** -0.5),
        "mlstm_conv_b": nrm(ks[9], (L, 2 * GROUP_WIDTH), 0.02),
        "mlstm_gate_b": nrm(ks[10], (L, 2, H), 0.1) + jnp.array([0.0, 3.0], jnp.float32)[None, :, None],
        "mlstm_norm_g": 1.0 + nrm(ks[11], (L, HEAD_DIM), 0.02),
        "w_out": nrm(ks[12], (L, MIX_WIDTH, D_MODEL), MIX_WIDTH ** -0.5 * BETA),
        "ln1_g": 1.0 + nrm(ks[13], (L, D_MODEL), 0.02),
        "ln1_b": nrm(ks[14], (L, D_MODEL), 0.02),
        "w_gate": nrm(ks[15], (L, D_MODEL, D_FF), D_MODEL ** -0.5),
        "w_up": nrm(ks[16], (L, D_MODEL, D_FF), D_MODEL ** -0.5),
        "w_down": nrm(ks[17], (L, D_FF, D_MODEL), D_FF ** -0.5 * BETA),
        "ln2_g": 1.0 + nrm(ks[18], (L, D_MODEL), 0.02),
        "ln2_b": nrm(ks[19], (L, D_MODEL), 0.02),
    }


def reference(x, w_in, diff_lambda, diff_subln_g, sgu_ln_g, sgu_ln_b, sgu_w, sgu_b,
              mlstm_conv_w, mlstm_conv_b, mlstm_gate_b, mlstm_norm_g, w_out,
              ln1_g, ln1_b, w_gate, w_up, w_down, ln2_g, ln2_b):
    S = x.shape[1]
    rope_a = rope_tables(S, DIFF_QK_DIM)
    rope_c = rope_tables(S, HEAD_DIM)
    for l in range(DEPTH):
        lam_init = 0.8 - 0.6 * math.exp(-0.3 * l)
        h = mixer_block(x, w_in[l], diff_lambda[l], lam_init, diff_subln_g[l], sgu_ln_g[l], sgu_ln_b[l],
                        sgu_w[l], sgu_b[l], mlstm_conv_w[l], mlstm_conv_b[l], mlstm_gate_b[l],
                        mlstm_norm_g[l], w_out[l], rope_a, rope_c)
        x = layer_norm(ALPHA * x + h, ln1_g[l], ln1_b[l])
        f = swiglu(x, w_gate[l], w_up[l], w_down[l])
        x = layer_norm(ALPHA * x + f, ln2_g[l], ln2_b[l])
    return x
```

```cpp
#include <hip/hip_runtime.h>
#include <hip/hip_cooperative_groups.h>
#include <cstdint>
#include <cstdio>
namespace cg = cooperative_groups;

#define DI __device__ __forceinline__
#define LAS __attribute__((address_space(3)))
typedef _Float16 h16;
typedef _Float16 h16x2 __attribute__((ext_vector_type(2)));
typedef _Float16 h16x4 __attribute__((ext_vector_type(4)));
typedef _Float16 h16x8 __attribute__((ext_vector_type(8)));
typedef short v4i16_t __attribute__((ext_vector_type(4)));
typedef float f32x2 __attribute__((ext_vector_type(2)));
typedef float f32x4 __attribute__((ext_vector_type(4)));
typedef float f32x16 __attribute__((ext_vector_type(16)));
typedef unsigned u32x2 __attribute__((ext_vector_type(2)));
typedef unsigned u32x4 __attribute__((ext_vector_type(4)));

constexpr int SEQ = 8192, NB = 2, M = NB * SEQ, D = 1024, NZ = 3072, INW = 3080, DFF = 2816, NGU = 2 * DFF, DEPTH = 4;
constexpr float LN_EPS = 1e-5f;
constexpr float ALPHA = 1.681792830507429f;
constexpr float LOG2E = 1.4426950408889634f;
constexpr float SC_A = 0.17677669529663687f * LOG2E;
constexpr float SC_C = 0.125f * LOG2E;
constexpr int C_AQ = 0, C_AK = 256, C_AV = 512, C_BU = 768, C_BV = 1024, C_CQ = 1280, C_CK = 1536, C_CV = 1792, C_DQ = 2048, C_DK = 2304, C_DV = 2560, C_DO = 2816;

constexpr size_t MiB = 1u << 20;
constexpr size_t WS_ROPEA = 1 * MiB;
constexpr size_t WS_ROPEC = WS_ROPEA + 256 * 1024;
constexpr size_t WS_WG16 = WS_ROPEC + 512 * 1024;
constexpr size_t WS_SW16 = WS_WG16 + 64 * 1024;
constexpr size_t WS_WIN = 2 * MiB;
constexpr size_t WS_WOUT = 8 * MiB;
constexpr size_t WS_WGU = 10 * MiB;
constexpr size_t WS_WDN = 21 * MiB;
constexpr size_t WS_XH = 27 * MiB;
constexpr size_t WS_MIX = 59 * MiB;
constexpr size_t WS_R1 = 91 * MiB;
constexpr size_t WS_R2 = 187 * MiB;
constexpr size_t WS_DILO = WS_R2;
constexpr size_t WS_DILL = WS_R2 + 24 * MiB;
constexpr size_t WS_CLOC = WS_R2 + 25 * MiB;
constexpr size_t WS_NLOC = WS_R2 + 33 * MiB;
constexpr size_t WS_GM = WS_NLOC + 128 * 1024;
constexpr size_t WS_BL = WS_GM + 4096;
constexpr size_t WS_BCUM = WS_R2 + 34 * MiB;
constexpr size_t WS_AVAL = WS_BCUM + 256 * 1024;
constexpr size_t WS_AMAXP = WS_AVAL + 256 * 1024;
constexpr size_t WS_END = 251 * MiB;

constexpr int LDS_BYTES = 147456;

DI float ex2(float x) { return __builtin_amdgcn_exp2f(x); }
DI float lg2(float x) { return __builtin_amdgcn_logf(x); }
DI float fexp(float x) { return ex2(x * LOG2E); }
DI float sigmoidf_(float x) { return 1.f / (1.f + fexp(-x)); }
DI float siluf_(float x) { return x / (1.f + fexp(-x)); }
DI float geluf_(float x) { const float y = 0.7978845608028654f * (x + 0.044715f * x * x * x); const float e = ex2(y * (2.f * LOG2E)); const float t = 1.f - 2.f / (1.f + e); return 0.5f * x * (1.f + t); }
DI float logsigf_(float x) { return fminf(x, 0.f) - 0.6931471805599453f * lg2(1.f + fexp(-fabsf(x))); }
DI float xh_sum(float v) { auto rr = __builtin_amdgcn_permlane32_swap(__float_as_uint(v), __float_as_uint(v), false, false); return __uint_as_float(rr[0]) + __uint_as_float(rr[1]); }
DI float xh_max(float v) { auto rr = __builtin_amdgcn_permlane32_swap(__float_as_uint(v), __float_as_uint(v), false, false); return fmaxf(__uint_as_float(rr[0]), __uint_as_float(rr[1])); }
DI float wave_sum(float v) {
#pragma unroll
    for (int o = 1; o < 64; o <<= 1) v += __shfl_xor(v, o);
    return v;
}
DI int launder(int x) { asm volatile("" : "+v"(x)); return x; }
DI int crow(int i, int hf) { return (i & 3) + 8 * (i >> 2) + 4 * hf; }
DI unsigned pk_rne(float a, float b) { h16x2 v; v[0] = (h16)a; v[1] = (h16)b; return __builtin_bit_cast(unsigned, v); }
DI unsigned pk_rtz(float a, float b) { return __builtin_bit_cast(unsigned, __builtin_amdgcn_cvt_pkrtz(a, b)); }
DI h16x8 ld_h8(const h16* p) { return *(const h16x8*)p; }
DI h16x4 ld_h4(const h16* p) { return *(const h16x4*)p; }

namespace pg8 {
constexpr int BM = 256, BK = 64, HALF = 128, HTB = HALF * BK * 2, STAGE_BYTES = 8 * HTB, NXCD = 8, WGM = 8;
__host__ __device__ __forceinline__ int lds_byte(int r, int c) { const int st = (r >> 4) * 2 + (c >> 5), rr = r & 15, cc = c & 31, ob = rr * 64 + cc * 2; return st * 1024 + (ob ^ (((ob >> 9) & 1) << 5)); }
__host__ __device__ __forceinline__ void stage_rc(int b, int& R, int& C) { const int st = b / 1024, sb = b % 1024, swz = sb ^ (((sb >> 9) & 1) << 5); R = (st >> 1) * 16 + swz / 64; C = (st & 1) * 32 + (swz % 64) / 2; }
__host__ __device__ __forceinline__ int perm32(int rho) { const int n = rho >> 4, i = rho & 15; return 8 * (i >> 2) + 4 * n + (i & 3); }
struct Unit { int pm, pn; };
struct Gemm { const h16* A; const h16* Bt; int M, N, K; };
struct StaticOrder {
    int nM, nN, nwg, G, c;
    __host__ __device__ void init(int M_, int N_, int G_, int c_) { nM = M_ / BM; nN = N_ / BM; nwg = nM * nN; G = G_; c = c_; }
    __host__ __device__ bool next(int i, Unit& u) const {
        const long L = (long)i * G + c; if (L >= nwg) return false;
        int wgid = (int)L; { const int q = nwg / NXCD, r = nwg % NXCD, xcd = wgid % NXCD, off = wgid / NXCD; wgid = (xcd < r ? xcd * (q + 1) : r * (q + 1) + (xcd - r) * q) + off; }
        const int nig = WGM * nN, gid = wgid / nig, fm = gid * WGM, gsz = (nM - fm) < WGM ? (nM - fm) : WGM;
        u.pm = fm + ((wgid % nig) % gsz); u.pn = (wgid % nig) / gsz; return true;
    }
    __device__ __forceinline__ void a_ready(const Unit&) const {}
    __device__ __forceinline__ void done(const Unit&) const {}
};

template <class Epi, class Sched, bool ALIGN_EPI = false, bool SP2 = false>
__device__ __forceinline__ void gemm_phase(LAS unsigned char* lds, const Gemm g, const Sched& S, const Epi& E) {
    const int tid = launder(threadIdx.x), wid = __builtin_amdgcn_readfirstlane(tid >> 6), lane = tid & 63, wr = wid >> 2, wc = wid & 3, fr = lane & 15, fq = lane >> 4;
    const int K = g.K, nt = K / BK;
    unsigned voffA[2], voffB[2];
#pragma unroll
    for (int i = 0; i < 2; ++i) { int R, C; stage_rc(tid * 16 + i * 8192, R, C); const int Rb = Epi::PERM ? ((R & ~31) + perm32(R & 31)) : R;
        voffA[i] = (unsigned)(R * K + C) * 2u; voffB[i] = (unsigned)(Rb * K + C) * 2u; }
    const size_t kstep = (size_t)(BK * 2);
    const size_t hstep = (size_t)HALF * K * 2;
    const size_t tstep = 2 * hstep;
    const unsigned ldsw = (unsigned)wid * 1024u;
    const int aoff = lds_byte(wr * 64 + fr, fq * 8), boff = lds_byte(wc * 32 + fr, fq * 8);
#define PG8_SA(b, h) (((b) * 2 + (h)) * HTB)
#define PG8_SB(b, h) ((4 + (b) * 2 + (h)) * HTB)
#define PG8_STAGE(bufoff, gbase, voff) do { _Pragma("unroll") for (int _i = 0; _i < 2; ++_i) \
        __builtin_amdgcn_global_load_lds((const unsigned*)((const char*)(gbase) + (voff)[_i]), (LAS unsigned*)(lds + (bufoff) + ldsw + _i * 8192), 16, 0, 0); } while (0)
#define PG8_LDA(dst, b, h) do { _Pragma("unroll") for (int m = 0; m < 4; ++m) _Pragma("unroll") for (int k = 0; k < 2; ++k) dst[m][k] = *(const LAS h16x8*)(lds + PG8_SA(b, h) + aoff + m * 2048 + k * 1024); } while (0)
#define PG8_LDB(dst, b, h) do { _Pragma("unroll") for (int n = 0; n < 2; ++n) _Pragma("unroll") for (int k = 0; k < 2; ++k) dst[n][k] = *(const LAS h16x8*)(lds + PG8_SB(b, h) + boff + n * 2048 + k * 1024); } while (0)
#define PG8_MMA(ai, bj, At, Bt) do { __builtin_amdgcn_s_setprio(1); _Pragma("unroll") for (int m = 0; m < 4; ++m) _Pragma("unroll") for (int n = 0; n < 2; ++n) _Pragma("unroll") for (int k = 0; k < 2; ++k) \
        acc[ai][bj][m][n] = __builtin_amdgcn_mfma_f32_16x16x32_f16(Bt[n][k], At[m][k], acc[ai][bj][m][n], 0, 0, 0); __builtin_amdgcn_s_setprio(0); } while (0)
#define PG8_WAIT_V(n) asm volatile("s_waitcnt vmcnt(" #n ")" ::: "memory")
#define PG8_WAIT_L(n) asm volatile("s_waitcnt lgkmcnt(" #n ")" ::: "memory")
#define PG8_BAR __builtin_amdgcn_s_barrier()
#define PG8_SCHED __builtin_amdgcn_sched_barrier(0)
    Unit cur, nxt; int ui = 0;
    if (!S.next(0, cur)) return;
    f32x4 acc[2][2][4][2];
#pragma unroll
    for (int a = 0; a < 2; ++a)
#pragma unroll
        for (int b = 0; b < 2; ++b)
#pragma unroll
            for (int m = 0; m < 4; ++m)
#pragma unroll
                for (int n = 0; n < 2; ++n) acc[a][b][m][n] = (f32x4){0.f, 0.f, 0.f, 0.f};
    h16x8 At[4][2], B0[2][2], B1[2][2];
    const char* cA = (const char*)g.A + (size_t)cur.pm * tstep; const char* cB = (const char*)g.Bt + (size_t)cur.pn * tstep;
    S.a_ready(cur);
    if constexpr (SP2) {
        PG8_STAGE(PG8_SB(0, 0), cB, voffB); PG8_STAGE(PG8_SB(0, 1), cB + hstep, voffB); PG8_STAGE(PG8_SA(0, 0), cA, voffA); PG8_STAGE(PG8_SA(0, 1), cA + hstep, voffA);
        if (wr == 1) PG8_BAR;
        PG8_WAIT_V(2); PG8_BAR;
        PG8_STAGE(PG8_SB(1, 0), cB + kstep, voffB); PG8_STAGE(PG8_SA(1, 0), cA + kstep, voffA); PG8_STAGE(PG8_SB(1, 1), cB + hstep + kstep, voffB);
        PG8_WAIT_V(6); PG8_BAR;
    } else {
        PG8_STAGE(PG8_SB(0, 0), cB, voffB); PG8_STAGE(PG8_SA(0, 0), cA, voffA); PG8_STAGE(PG8_SB(0, 1), cB + hstep, voffB); PG8_STAGE(PG8_SA(0, 1), cA + hstep, voffA);
        if (wr == 1) PG8_BAR;
        PG8_WAIT_V(4); PG8_BAR;
        PG8_STAGE(PG8_SB(1, 0), cB + kstep, voffB); PG8_STAGE(PG8_SA(1, 0), cA + kstep, voffA); PG8_STAGE(PG8_SB(1, 1), cB + hstep + kstep, voffB);
        PG8_WAIT_V(6); PG8_BAR;
    }
    for (;;) {
        const bool has_next = S.next(ui + 1, nxt);
        const char* nA = has_next ? (const char*)g.A + (size_t)nxt.pm * tstep : cA; const char* nB = has_next ? (const char*)g.Bt + (size_t)nxt.pn * tstep : cB;
        for (int t = 0; t < nt; t += 2) {
            const bool last = (t == nt - 2);
            const char* a1 = cA + (size_t)(t + 1) * kstep;
            const char* a2 = last ? nA : cA + (size_t)(t + 2) * kstep; const char* b2 = last ? nB : cB + (size_t)(t + 2) * kstep;
            const char* a3 = a2 + kstep; const char* b3 = b2 + kstep;
            if (last && has_next) S.a_ready(nxt);
            if constexpr (SP2) {
            PG8_LDB(B0, 0, 0); PG8_LDB(B1, 0, 1); PG8_SCHED; PG8_LDA(At, 0, 0); PG8_STAGE(PG8_SA(1, 1), a1 + hstep, voffA);
            PG8_WAIT_V(8); PG8_WAIT_L(0); PG8_BAR; PG8_MMA(0, 0, At, B0); PG8_MMA(0, 1, At, B1); PG8_BAR; PG8_SCHED;
            PG8_LDA(At, 0, 1); PG8_STAGE(PG8_SB(0, 0), b2, voffB); PG8_STAGE(PG8_SB(0, 1), b2 + hstep, voffB); PG8_STAGE(PG8_SA(0, 0), a2, voffA);
            PG8_WAIT_V(8); PG8_WAIT_L(0); PG8_BAR; PG8_MMA(1, 0, At, B0); PG8_MMA(1, 1, At, B1); PG8_BAR; PG8_SCHED;
            PG8_LDB(B0, 1, 0); PG8_LDB(B1, 1, 1); PG8_SCHED; PG8_LDA(At, 1, 0); PG8_STAGE(PG8_SA(0, 1), a2 + hstep, voffA);
            PG8_WAIT_V(8); PG8_WAIT_L(0); PG8_BAR; PG8_MMA(0, 0, At, B0); PG8_MMA(0, 1, At, B1); PG8_BAR; PG8_SCHED;
            PG8_LDA(At, 1, 1); PG8_STAGE(PG8_SB(1, 0), b3, voffB); PG8_STAGE(PG8_SB(1, 1), b3 + hstep, voffB); PG8_STAGE(PG8_SA(1, 0), a3, voffA);
            PG8_WAIT_V(8); PG8_WAIT_L(0); PG8_BAR; PG8_MMA(1, 0, At, B0); PG8_MMA(1, 1, At, B1); PG8_BAR; PG8_SCHED;
            } else {
            PG8_LDB(B0, 0, 0); PG8_SCHED; PG8_LDA(At, 0, 0); PG8_STAGE(PG8_SA(1, 1), a1 + hstep, voffA);
            PG8_WAIT_L(8); PG8_BAR; PG8_WAIT_L(0); PG8_MMA(0, 0, At, B0); PG8_BAR; PG8_SCHED;
            PG8_LDB(B1, 0, 1); PG8_STAGE(PG8_SB(0, 0), b2, voffB);
            PG8_BAR; PG8_WAIT_L(0); PG8_MMA(0, 1, At, B1); PG8_BAR;
            PG8_LDA(At, 0, 1); PG8_STAGE(PG8_SA(0, 0), a2, voffA);
            PG8_BAR; PG8_WAIT_L(0); PG8_MMA(1, 0, At, B0); PG8_BAR; PG8_SCHED;
            PG8_STAGE(PG8_SB(0, 1), b2 + hstep, voffB);
            PG8_WAIT_V(6); PG8_BAR; PG8_MMA(1, 1, At, B1); PG8_BAR;
            PG8_LDB(B0, 1, 0); PG8_SCHED; PG8_LDA(At, 1, 0); PG8_STAGE(PG8_SA(0, 1), a2 + hstep, voffA);
            PG8_WAIT_L(8); PG8_BAR; PG8_WAIT_L(0); PG8_MMA(0, 0, At, B0); PG8_BAR; PG8_SCHED;
            PG8_LDB(B1, 1, 1); PG8_STAGE(PG8_SB(1, 0), b3, voffB);
            PG8_BAR; PG8_WAIT_L(0); PG8_MMA(0, 1, At, B1); PG8_BAR;
            PG8_LDA(At, 1, 1); PG8_STAGE(PG8_SA(1, 0), a3, voffA);
            PG8_BAR; PG8_WAIT_L(0); PG8_MMA(1, 0, At, B0); PG8_BAR; PG8_SCHED;
            PG8_STAGE(PG8_SB(1, 1), b3 + hstep, voffB);
            PG8_WAIT_V(6); PG8_BAR; PG8_MMA(1, 1, At, B1); PG8_BAR;
            }
        }
        if constexpr (ALIGN_EPI) { if (wr == 0) PG8_BAR; }
        E(acc, cur, wr, wc, fr, fq); S.done(cur);
        if (!has_next) break;
#pragma unroll
        for (int a = 0; a < 2; ++a)
#pragma unroll
            for (int b = 0; b < 2; ++b)
#pragma unroll
                for (int m = 0; m < 4; ++m)
#pragma unroll
                    for (int n = 0; n < 2; ++n) acc[a][b][m][n] = (f32x4){0.f, 0.f, 0.f, 0.f};
        cur = nxt; cA = nA; cB = nB; ++ui;
        if constexpr (ALIGN_EPI) { if (wr == 1) PG8_BAR; }
    }
    PG8_WAIT_V(0);
    if constexpr (!ALIGN_EPI) { if (wr == 0) PG8_BAR; }
    PG8_BAR;
#undef PG8_SA
#undef PG8_SB
#undef PG8_STAGE
#undef PG8_LDA
#undef PG8_LDB
#undef PG8_MMA
#undef PG8_WAIT_V
#undef PG8_WAIT_L
#undef PG8_BAR
#undef PG8_SCHED
}

struct EpiZ {
    static constexpr bool PERM = true;
    h16* Z; const float* ropeA; const float* ropeC;
    __device__ __forceinline__ void operator()(const f32x4 (&acc)[2][2][4][2], const Unit& u, int wr, int wc, int fr, int fq) const {
        const int pn = u.pn;
#pragma unroll
        for (int ai = 0; ai < 2; ++ai)
#pragma unroll
            for (int m = 0; m < 4; ++m) {
                const int row = u.pm * BM + ai * HALF + wr * 64 + m * 16 + fr; const int pos = row & (SEQ - 1);
#pragma unroll
                for (int bj = 0; bj < 2; ++bj) {
                    f32x4 v0 = acc[ai][bj][m][0], v1 = acc[ai][bj][m][1];
                    const int c8 = pn * BM + bj * HALF + wc * 32 + 8 * fq;
                    if (pn == 0 || pn == 1) {
                        if (fq == 0) { const f32x4 cs = *(const f32x4*)(ropeA + pos * 8), sn = *(const f32x4*)(ropeA + pos * 8 + 4);
                            const f32x4 a = v0 * cs - v1 * sn, b = v1 * cs + v0 * sn; v0 = a; v1 = b; }
                        if (pn == 0) { v0 = v0 * SC_A; v1 = v1 * SC_A; }
                    } else if (pn == 5 || pn == 6) {
                        f32x4 o0, o1;
#pragma unroll
                        for (int i = 0; i < 4; ++i) { o0[i] = __shfl_xor(v0[i], 16); o1[i] = __shfl_xor(v1[i], 16); }
                        if ((wc & 1) == 0 && fq < 2) {
                            const f32x4 c0 = *(const f32x4*)(ropeC + pos * 16), c1 = *(const f32x4*)(ropeC + pos * 16 + 4), s0 = *(const f32x4*)(ropeC + pos * 16 + 8), s1 = *(const f32x4*)(ropeC + pos * 16 + 12);
                            if (fq == 0) { v0 = v0 * c0 - o0 * s0; v1 = v1 * c1 - o1 * s1; }
                            else         { v0 = v0 * c0 + o0 * s0; v1 = v1 * c1 + o1 * s1; }
                        }
                        if (pn == 5) { v0 = v0 * SC_C; v1 = v1 * SC_C; }
                    }
                    u32x4 w; w.x = pk_rne(v0[0], v0[1]); w.y = pk_rne(v0[2], v0[3]); w.z = pk_rne(v1[0], v1[1]); w.w = pk_rne(v1[2], v1[3]);
                    *(u32x4*)(Z + (size_t)row * NZ + c8) = w;
                }
            }
    }
};
struct EpiRes {
    static constexpr bool PERM = true;
    const float* res; float* Y;
    __device__ __forceinline__ void operator()(const f32x4 (&acc)[2][2][4][2], const Unit& u, int wr, int wc, int fr, int fq) const {
#pragma unroll
        for (int ai = 0; ai < 2; ++ai)
#pragma unroll
            for (int m = 0; m < 4; ++m) {
                const int row = u.pm * BM + ai * HALF + wr * 64 + m * 16 + fr;
#pragma unroll
                for (int bj = 0; bj < 2; ++bj) {
                    const int c8 = u.pn * BM + bj * HALF + wc * 32 + 8 * fq; const size_t off = (size_t)row * D + c8;
                    const f32x4 r0 = *(const f32x4*)(res + off), r1 = *(const f32x4*)(res + off + 4);
                    *(f32x4*)(Y + off) = r0 * ALPHA + acc[ai][bj][m][0]; *(f32x4*)(Y + off + 4) = r1 * ALPHA + acc[ai][bj][m][1];
                }
            }
    }
};
struct EpiSwiglu {
    static constexpr bool PERM = true;
    h16* ACT;
    __device__ __forceinline__ void operator()(const f32x4 (&acc)[2][2][4][2], const Unit& u, int wr, int wc, int fr, int fq) const {
#pragma unroll
        for (int ai = 0; ai < 2; ++ai)
#pragma unroll
            for (int m = 0; m < 4; ++m) {
                const int row = u.pm * BM + ai * HALF + wr * 64 + m * 16 + fr;
#pragma unroll
                for (int bj = 0; bj < 2; ++bj) {
                    const int c8 = u.pn * BM + bj * HALF + wc * 32 + 8 * fq;
                    const f32x4 g = acc[ai][bj][m][0], up = acc[ai][bj][m][1];
                    u32x2 w; w.x = pk_rne(siluf_(g[0]) * up[0], siluf_(g[1]) * up[1]); w.y = pk_rne(siluf_(g[2]) * up[2], siluf_(g[3]) * up[3]);
                    *(u32x2*)(ACT + (size_t)row * DFF + (c8 >> 1)) = w;
                }
            }
    }
};
}

struct Args {
    const float *x, *w_in, *diff_lambda, *diff_subln_g, *sgu_ln_g, *sgu_ln_b, *sgu_w, *sgu_b, *conv_w, *conv_b, *gate_b, *mnorm_g, *w_out, *ln1_g, *ln1_b, *w_gate, *w_up, *w_down, *ln2_g, *ln2_b;
    float* out; unsigned char* ws;
};

template <int MODE>
DI void transpose_item(const float* W, int ldw, int N, int K, h16* WT, LAS float* scr, int item, int lane) {
    const int nblk = N / 32, kb = item / nblk, nb = item % nblk, k0 = 64 * kb, n0 = 32 * nb;
#pragma unroll 8
    for (int i = 0; i < 32; ++i) { const int kk = 2 * i + (lane >> 5); scr[kk * 33 + (lane & 31)] = W[(size_t)(k0 + kk) * ldw + n0 + (lane & 31)]; }
    asm volatile("s_waitcnt lgkmcnt(0)" ::: "memory");
    const int c = lane & 7;
#pragma unroll
    for (int j = 0; j < 4; ++j) { const int n = (lane >> 3) + 8 * j; const LAS float* s = scr + (8 * c) * 33 + n;
        u32x4 o; o.x = pk_rne(s[0 * 33], s[1 * 33]); o.y = pk_rne(s[2 * 33], s[3 * 33]); o.z = pk_rne(s[4 * 33], s[5 * 33]); o.w = pk_rne(s[6 * 33], s[7 * 33]);
        const int nn = n0 + n; const int r = MODE == 0 ? nn : (2 * (nn & ~3) + (nn & 3) + (MODE == 2 ? 4 : 0));
        *(u32x4*)(WT + (size_t)r * K + k0 + 8 * c) = o; }
    asm volatile("s_waitcnt lgkmcnt(0)" ::: "memory");
}
DI void convert_weights(const Args& a, int l, LAS unsigned char* lds) {
    const int tid = launder(threadIdx.x), lane = tid & 63, wave = tid >> 6;
    LAS float* scr = (LAS float*)(lds + wave * 16384);
    const int gw = blockIdx.x * 8 + wave, NGW = gridDim.x * 8;
    const float* w_in = a.w_in + (size_t)l * D * INW; const float* w_out = a.w_out + (size_t)l * D * D;
    const float* w_gate = a.w_gate + (size_t)l * D * DFF; const float* w_up = a.w_up + (size_t)l * D * DFF; const float* w_down = a.w_down + (size_t)l * DFF * D;
    h16* WIN = (h16*)(a.ws + WS_WIN); h16* WOUT = (h16*)(a.ws + WS_WOUT); h16* WGU = (h16*)(a.ws + WS_WGU); h16* WDN = (h16*)(a.ws + WS_WDN);
    constexpr int I_IN = (D / 64) * (NZ / 32), I_OUT = (D / 64) * (D / 32), I_G = (D / 64) * (DFF / 32), I_D = (DFF / 64) * (D / 32);
    constexpr int NIT = I_IN + I_OUT + 2 * I_G + I_D;
    for (int it = gw; it < NIT; it += NGW) {
        int r = it;
        if (r < I_IN) { transpose_item<0>(w_in, INW, NZ, D, WIN, scr, r, lane); continue; } r -= I_IN;
        if (r < I_OUT) { transpose_item<0>(w_out, D, D, D, WOUT, scr, r, lane); continue; } r -= I_OUT;
        if (r < I_G) { transpose_item<1>(w_gate, DFF, DFF, D, WGU, scr, r, lane); continue; } r -= I_G;
        if (r < I_G) { transpose_item<2>(w_up, DFF, DFF, D, WGU, scr, r, lane); continue; } r -= I_G;
        transpose_item<0>(w_down, D, D, DFF, WDN, scr, r, lane);
    }
    const int gt = blockIdx.x * 512 + tid, NGT = gridDim.x * 512;
    h16* WG = (h16*)(a.ws + WS_WG16);
    for (int i = gt; i < 16 * 1024; i += NGT) { const int c = i >> 10, k = i & 1023; WG[i] = c < 8 ? (h16)w_in[(size_t)k * INW + NZ + c] : (h16)0.f; }
    h16* SW = (h16*)(a.ws + WS_SW16); const float* sw = a.sgu_w + (size_t)l * 4 * 128 * 128;
    for (int i = gt; i < 4 * 128 * 128; i += NGT) { const int s = i & 127, t = (i >> 7) & 127; SW[i] = s <= t ? (h16)sw[i] : (h16)0.f; }
}
DI void sincos_red(float ang, float& c, float& s) {
    const float k = rintf(ang * 0.15915494309189535f);
    float r = fmaf(-k, 6.28125f, ang); r = fmaf(-k, 1.9353071795864769e-3f, r);
    c = __cosf(r); s = __sinf(r);
}
DI void prologue(const Args& a, LAS unsigned char* lds) {
    const int gt = blockIdx.x * 512 + launder(threadIdx.x), NGT = gridDim.x * 512;
    float* ropeA = (float*)(a.ws + WS_ROPEA); float* ropeC = (float*)(a.ws + WS_ROPEC);
    for (int i = gt; i < SEQ * 12; i += NGT) {
        const int pos = i / 12, j = i % 12; float inv;
        if (j < 4) { const float t4[4] = {1.0f, 0.037606030930863934f, 0.0014142135623730951f, 5.3183958899138e-05f}; inv = j == 0 ? t4[0] : j == 1 ? t4[1] : j == 2 ? t4[2] : t4[3]; }
        else { const int q = j - 4; inv = q == 0 ? 1.0f : q == 1 ? 0.19392274096655273f : q == 2 ? 0.037606030930863934f : q == 3 ? 0.007292664590796897f : q == 4 ? 0.0014142135623730951f : q == 5 ? 0.00027425117245089507f : q == 6 ? 5.3183958899138e-05f : 1.0313579087e-05f; }
        float c, s; sincos_red((float)pos * inv, c, s);
        if (j < 4) { ropeA[pos * 8 + j] = c; ropeA[pos * 8 + 4 + j] = s; } else { ropeC[pos * 16 + (j - 4)] = c; ropeC[pos * 16 + 8 + (j - 4)] = s; }
    }
    h16* XH = (h16*)(a.ws + WS_XH);
    for (int i = gt; i < M * D / 8; i += NGT) { const f32x4 v0 = *(const f32x4*)(a.x + (size_t)i * 8), v1 = *(const f32x4*)(a.x + (size_t)i * 8 + 4);
        u32x4 w; w.x = pk_rne(v0[0], v0[1]); w.y = pk_rne(v0[2], v0[3]); w.z = pk_rne(v1[0], v1[1]); w.w = pk_rne(v1[2], v1[3]); *(u32x4*)(XH + (size_t)i * 8) = w; }
    convert_weights(a, 0, lds);
}
DI void ln_phase(const float* Y, const float* g, const float* b, float* out, h16* XH) {
    const int tidl = launder(threadIdx.x); const int lane = tidl & 63, gw = blockIdx.x * 8 + (tidl >> 6), NGW = gridDim.x * 8;
    f32x4 gv[4], bv[4];
#pragma unroll
    for (int j = 0; j < 4; ++j) { gv[j] = *(const f32x4*)(g + 4 * lane + 256 * j); bv[j] = *(const f32x4*)(b + 4 * lane + 256 * j); }
    for (int m = gw; m < M; m += NGW) {
        const float* yr = Y + (size_t)m * D + 4 * lane; f32x4 v[4]; float s = 0.f;
#pragma unroll
        for (int j = 0; j < 4; ++j) { v[j] = *(const f32x4*)(yr + 256 * j); s += (v[j][0] + v[j][1]) + (v[j][2] + v[j][3]); }
        const float mean = wave_sum(s) * (1.f / D); float s2 = 0.f;
#pragma unroll
        for (int j = 0; j < 4; ++j) { v[j] = v[j] - mean; s2 += (v[j][0] * v[j][0] + v[j][1] * v[j][1]) + (v[j][2] * v[j][2] + v[j][3] * v[j][3]); }
        const float rstd = 1.f / sqrtf(wave_sum(s2) * (1.f / D) + LN_EPS);
#pragma unroll
        for (int j = 0; j < 4; ++j) { const f32x4 o = v[j] * rstd * gv[j] + bv[j]; *(f32x4*)(out + (size_t)m * D + 4 * lane + 256 * j) = o;
            u32x2 w; w.x = pk_rne(o[0], o[1]); w.y = pk_rne(o[2], o[3]); *(u32x2*)(XH + (size_t)m * D + 4 * lane + 256 * j) = w; }
    }
}

DI int koff(int key, int ch) { return key * 128 + ((ch ^ ((key >> 1) & 7)) << 4); }
DI int voff(int key, int ch) { return key * 128 + ((ch ^ (((key >> 1) & 1) << 2)) << 4); }
template <int NM> DI void qk_block(f32x16 (&S)[NM], const LAS unsigned char* Kt, int rowbase, const h16x8 (&qf)[4], int r32, int hf) {
    const int key = rowbase + r32; const LAS unsigned char* rp = Kt + key * 128; const int sw = (key >> 1) & 7;
    const f32x16 z = {0.f, 0.f, 0.f, 0.f, 0.f, 0.f, 0.f, 0.f, 0.f, 0.f, 0.f, 0.f, 0.f, 0.f, 0.f, 0.f};
#pragma unroll
    for (int m = 0; m < NM; ++m) S[m] = z;
#pragma unroll
    for (int ks = 0; ks < 4; ++ks) {
        const h16x8 kf = *(const LAS h16x8*)(rp + (((2 * ks + hf) ^ sw) << 4));
        const int m = NM == 2 ? (ks >> 1) : 0;
        S[m] = __builtin_amdgcn_mfma_f32_32x32x16_f16(kf, qf[ks], S[m], 0, 0, 0);
    }
}
DI h16x8 tr_frag(const LAS unsigned char* p) {
    const v4i16_t lo = __builtin_amdgcn_ds_read_tr16_b64_v4i16((LAS v4i16_t*)p);
    const v4i16_t hi = __builtin_amdgcn_ds_read_tr16_b64_v4i16((LAS v4i16_t*)(p + 8 * 128));
    typedef short s16x8 __attribute__((ext_vector_type(8)));
    const s16x8 r = {lo[0], lo[1], lo[2], lo[3], hi[0], hi[1], hi[2], hi[3]};
    return __builtin_bit_cast(h16x8, r);
}
DI void pv_block(f32x16 (&O)[2], const LAS unsigned char* Vt, int rowbase, const f32x16& P, int lane) {
    const int i16 = lane & 15, q = i16 >> 2, p = i16 & 3, dvh = (lane >> 4) & 1, hf = lane >> 5;
#pragma unroll
    for (int s = 0; s < 2; ++s) {
        u32x4 pw; pw.x = pk_rtz(P[8 * s + 0], P[8 * s + 1]); pw.y = pk_rtz(P[8 * s + 2], P[8 * s + 3]); pw.z = pk_rtz(P[8 * s + 4], P[8 * s + 5]); pw.w = pk_rtz(P[8 * s + 6], P[8 * s + 7]);
        const h16x8 pb = __builtin_bit_cast(h16x8, pw);
        const int key1 = rowbase + 16 * s + 4 * hf + q;
#pragma unroll
        for (int dt = 0; dt < 2; ++dt) {
            const int colb = (64 * dt + 32 * dvh + 8 * p) ^ ((q >> 1) << 6);
            const h16x8 va = tr_frag(Vt + key1 * 128 + colb);
            O[dt] = __builtin_amdgcn_mfma_f32_32x32x16_f16(va, pb, O[dt], 0, 0, 0);
        }
    }
}

struct AttnOut {
    h16* MIX; const float* subln_g; float lam, one_m_lam_init;
    h16* DILO; float* DILL;
};
template <int MODE>
DI void attn_unit(LAS unsigned char* lds, const h16* __restrict__ Z, int qtok0, int qstride, int ktok0, int kstride, int st0, int st1,
                  int qcol, int kcol, int vcol, int qb, int h, const AttnOut& ao) {
    constexpr int NM = MODE == 0 ? 2 : 1;
    const int tid = launder(threadIdx.x), lane = tid & 63, wave = __builtin_amdgcn_readfirstlane(tid >> 6), hw = wave >> 2, w4 = wave & 3, r32 = lane & 31, hf = lane >> 5;
    const int iq = 32 * w4 + r32;
    const h16* qrow = Z + (size_t)(qtok0 + iq * qstride) * NZ + qcol + 8 * hf;
    h16x8 qf[4];
#pragma unroll
    for (int ks = 0; ks < 4; ++ks) qf[ks] = ld_h8(qrow + 16 * ks);
    f32x16 O[NM][2]; float mrun[NM], lrun[NM];
#pragma unroll
    for (int m = 0; m < NM; ++m) { mrun[m] = -INFINITY; lrun[m] = 0.f;
#pragma unroll
        for (int dt = 0; dt < 2; ++dt)
#pragma unroll
            for (int i = 0; i < 16; ++i) O[m][dt][i] = 0.f; }
    const int klo = MODE == 1 ? iq : 0, khi = MODE == 1 ? iq + 128 : 128 * qb + iq;
    const int klo_min = MODE == 1 ? 32 * w4 : 0, klo_max = MODE == 1 ? 32 * w4 + 31 : 0;
    const int khi_min = MODE == 1 ? 32 * w4 + 128 : 128 * qb + 32 * w4, khi_max = khi_min + 31;
    const int ch = tid & 7, keyA = tid >> 3, keyB = keyA + 64;
    const h16* kgA = Z + (size_t)(ktok0 + keyA * kstride) * NZ + ch * 8;
    const size_t dB = (size_t)64 * kstride * NZ, dStep = (size_t)128 * kstride * NZ;
    const int oKA = koff(keyA, ch), oKB = koff(keyB, ch), oVA = 16384 + voff(keyA, ch), oVB = 16384 + voff(keyB, ch);
    u32x4 rk0, rk1, rv0, rv1;
#define LOADST(st) do { const h16* p_ = kgA + (size_t)(st) * dStep; rk0 = *(const u32x4*)(p_ + kcol); rk1 = *(const u32x4*)(p_ + dB + kcol); rv0 = *(const u32x4*)(p_ + vcol); rv1 = *(const u32x4*)(p_ + dB + vcol); } while (0)
#define STOREST(sb) do { LAS unsigned char* b_ = lds + (sb) * 32768; *(LAS u32x4*)(b_ + oKA) = rk0; *(LAS u32x4*)(b_ + oKB) = rk1; *(LAS u32x4*)(b_ + oVA) = rv0; *(LAS u32x4*)(b_ + oVB) = rv1; } while (0)
    const int nst = st1 - st0 + 1;
    LOADST(st0);
    __syncthreads();
    STOREST(0);
    __syncthreads();
    for (int s = 0; s < nst; ++s) {
        const int cur = s & 1;
        if (s + 1 < nst) LOADST(st0 + s + 1);
        const LAS unsigned char* Kt = lds + cur * 32768 + hw * 8192; const LAS unsigned char* Vt = Kt + 16384;
        const int K0 = 128 * (st0 + s) + 64 * hw;
        bool sk[2]; f32x16 S[2][NM];
#pragma unroll
        for (int kb = 0; kb < 2; ++kb) {
            const int Kb0 = K0 + 32 * kb;
            sk[kb] = (Kb0 > khi_max) || (Kb0 + 31 < klo_min);
            if (!sk[kb]) {
                qk_block<NM>(S[kb], Kt, 32 * kb, qf, r32, hf);
                if (!(Kb0 >= klo_max && Kb0 + 31 <= khi_min)) {
#pragma unroll
                    for (int i = 0; i < 16; ++i) { const int kidx = Kb0 + crow(i, hf); const bool ok = (kidx >= klo) && (kidx <= khi);
#pragma unroll
                        for (int m = 0; m < NM; ++m) S[kb][m][i] = ok ? S[kb][m][i] : -INFINITY; }
                }
            } else {
#pragma unroll
                for (int m = 0; m < NM; ++m)
#pragma unroll
                    for (int i = 0; i < 16; ++i) S[kb][m][i] = -INFINITY;
            }
        }
        if (!(sk[0] && sk[1])) {
#pragma unroll
            for (int m = 0; m < NM; ++m) {
                float mx = S[0][m][0];
#pragma unroll
                for (int i = 0; i < 16; ++i) mx = fmaxf(mx, fmaxf(S[0][m][i], S[1][m][i]));
                mx = xh_max(mx);
                const float mnew = fmaxf(mrun[m], mx); const float muse = mnew == -INFINITY ? 0.f : mnew;
                const float alpha = ex2(mrun[m] - muse); float rs = 0.f;
#pragma unroll
                for (int i = 0; i < 16; ++i) { const float p0 = ex2(S[0][m][i] - muse), p1 = ex2(S[1][m][i] - muse); S[0][m][i] = p0; S[1][m][i] = p1; rs += p0 + p1; }
                lrun[m] = lrun[m] * alpha + rs; mrun[m] = mnew;
#pragma unroll
                for (int dt = 0; dt < 2; ++dt) O[m][dt] = O[m][dt] * alpha;
            }
#pragma unroll
            for (int kb = 0; kb < 2; ++kb) if (!sk[kb]) {
#pragma unroll
                for (int m = 0; m < NM; ++m) pv_block(O[m], Vt, 32 * kb, S[kb][m], lane);
            }
        }
        if (s + 1 < nst) STOREST(cur ^ 1);
        __syncthreads();
    }
#undef LOADST
#undef STOREST
    LAS float* cb = (LAS float*)(lds + w4 * 20480); LAS float* cs = (LAS float*)(lds + w4 * 20480 + 16384);
    float ltot[NM];
#pragma unroll
    for (int m = 0; m < NM; ++m) ltot[m] = xh_sum(lrun[m]);
    if (hw == 1) {
#pragma unroll
        for (int m = 0; m < NM; ++m) {
#pragma unroll
            for (int dt = 0; dt < 2; ++dt)
#pragma unroll
                for (int i = 0; i < 16; ++i) cb[((m * 2 + dt) * 16 + i) * 64 + lane] = O[m][dt][i];
            if (hf == 0) { cs[m * 64 + r32] = mrun[m]; cs[m * 64 + 32 + r32] = ltot[m]; }
        }
    }
    __syncthreads();
    if (hw == 0) {
        float invl[NM], mfin[NM], lfin[NM];
#pragma unroll
        for (int m = 0; m < NM; ++m) {
            const float mo = cs[m * 64 + r32], lo = cs[m * 64 + 32 + r32];
            const float mn = fmaxf(mrun[m], mo); const float mu = mn == -INFINITY ? 0.f : mn;
            const float fa = ex2(mrun[m] - mu), fb = ex2(mo - mu);
            const float l = ltot[m] * fa + lo * fb; invl[m] = 1.f / l; mfin[m] = mu; lfin[m] = l;
#pragma unroll
            for (int dt = 0; dt < 2; ++dt)
#pragma unroll
                for (int i = 0; i < 16; ++i) O[m][dt][i] = (O[m][dt][i] * fa + cb[((m * 2 + dt) * 16 + i) * 64 + lane] * fb) * invl[m];
        }
        const int tok = qtok0 + iq * qstride;
        if constexpr (MODE == 0) {
            float ss = 0.f;
#pragma unroll
            for (int dt = 0; dt < 2; ++dt)
#pragma unroll
                for (int i = 0; i < 16; ++i) { const float o = O[0][dt][i] - ao.lam * O[1][dt][i]; O[0][dt][i] = o; ss += o * o; }
            ss = xh_sum(ss);
            const float r = (1.f / sqrtf(ss * (1.f / 64.f) + LN_EPS)) * ao.one_m_lam_init;
            h16* orow = ao.MIX + (size_t)tok * D + h * 64;
#pragma unroll
            for (int dt = 0; dt < 2; ++dt)
#pragma unroll
                for (int g = 0; g < 4; ++g) { const int d = 32 * dt + 8 * g + 4 * hf; const f32x4 gg = *(const f32x4*)(ao.subln_g + d);
                    u32x2 w; w.x = pk_rne(O[0][dt][4 * g] * r * gg[0], O[0][dt][4 * g + 1] * r * gg[1]); w.y = pk_rne(O[0][dt][4 * g + 2] * r * gg[2], O[0][dt][4 * g + 3] * r * gg[3]);
                    *(u32x2*)(orow + d) = w; }
        } else {
            h16* orow = ao.DILO + (size_t)tok * 256 + h * 64;
#pragma unroll
            for (int dt = 0; dt < 2; ++dt)
#pragma unroll
                for (int g = 0; g < 4; ++g) { const int d = 32 * dt + 8 * g + 4 * hf;
                    u32x2 w; w.x = pk_rne(O[0][dt][4 * g], O[0][dt][4 * g + 1]); w.y = pk_rne(O[0][dt][4 * g + 2], O[0][dt][4 * g + 3]);
                    *(u32x2*)(orow + d) = w; }
            if (hf == 0) ao.DILL[(size_t)tok * 4 + h] = mfin[0] + lg2(lfin[0]);
        }
    }
}

DI void sgu_unit(LAS unsigned char* lds, const Args& a, int l, int item) {
    const int tid = launder(threadIdx.x), lane = tid & 63, wave = __builtin_amdgcn_readfirstlane(tid >> 6), r32 = lane & 31, hf = lane >> 5;
    const int T0 = item * 128;
    const h16* Z = (const h16*)(a.ws + WS_R1); h16* MIX = (h16*)(a.ws + WS_MIX); const h16* SW = (const h16*)(a.ws + WS_SW16);
    const float* lg = a.sgu_ln_g + l * 256; const float* lb = a.sgu_ln_b + l * 256; const float* bs = a.sgu_b + l * 512;
    constexpr int PITCH = 272;
    __syncthreads();
    {
        const f32x4 gv = *(const f32x4*)(lg + 4 * lane), bv = *(const f32x4*)(lb + 4 * lane);
        for (int tt = 0; tt < 16; ++tt) {
            const int t = 16 * wave + tt;
            const h16x4 hv = ld_h4(Z + (size_t)(T0 + t) * NZ + C_BV + 4 * lane);
            f32x4 v; float s = 0.f;
#pragma unroll
            for (int i = 0; i < 4; ++i) { v[i] = geluf_((float)hv[i]); s += v[i]; }
            const float mean = wave_sum(s) * (1.f / 256.f); float s2 = 0.f;
#pragma unroll
            for (int i = 0; i < 4; ++i) { v[i] -= mean; s2 += v[i] * v[i]; }
            const float rstd = 1.f / sqrtf(wave_sum(s2) * (1.f / 256.f) + LN_EPS);
#pragma unroll
            for (int i = 0; i < 4; ++i) *(LAS h16*)(lds + (4 * lane + i) * PITCH + t * 2) = (h16)(v[i] * rstd * gv[i] + bv[i]);
        }
    }
    __syncthreads();
    const int g = wave >> 1, th = wave & 1;
    f32x16 acc[2][2];
#pragma unroll
    for (int dt = 0; dt < 2; ++dt)
#pragma unroll
        for (int tt = 0; tt < 2; ++tt)
#pragma unroll
            for (int i = 0; i < 16; ++i) acc[dt][tt][i] = 0.f;
    const int smax = 64 * (th + 1);
    for (int s0 = 0; s0 < smax; s0 += 16) {
        h16x8 af[2];
#pragma unroll
        for (int dt = 0; dt < 2; ++dt) af[dt] = *(const LAS h16x8*)(lds + (g * 64 + 32 * dt + r32) * PITCH + (s0 + 8 * hf) * 2);
#pragma unroll
        for (int tt = 0; tt < 2; ++tt) {
            const int t0 = 64 * th + 32 * tt;
            if (s0 <= t0 + 31) {
                const h16x8 bf = ld_h8(SW + ((size_t)g * 128 + t0 + r32) * 128 + s0 + 8 * hf);
#pragma unroll
                for (int dt = 0; dt < 2; ++dt) acc[dt][tt] = __builtin_amdgcn_mfma_f32_32x32x16_f16(af[dt], bf, acc[dt][tt], 0, 0, 0);
            }
        }
    }
#pragma unroll
    for (int tt = 0; tt < 2; ++tt) {
        const int t = 64 * th + 32 * tt + r32; const size_t tok = T0 + t; const float bias = bs[g * 128 + t];
#pragma unroll
        for (int dt = 0; dt < 2; ++dt)
#pragma unroll
            for (int gq = 0; gq < 4; ++gq) { const int d = 32 * dt + 8 * gq + 4 * hf;
                const h16x4 uv = ld_h4(Z + tok * NZ + C_BU + g * 64 + d);
                float o[4];
#pragma unroll
                for (int i = 0; i < 4; ++i) o[i] = geluf_((float)uv[i]) * (acc[dt][tt][4 * gq + i] + bias);
                u32x2 w; w.x = pk_rne(o[0], o[1]); w.y = pk_rne(o[2], o[3]); *(u32x2*)(MIX + tok * D + 256 + g * 64 + d) = w; }
    }
}

DI void conv8(const h16* Z, size_t tok, int pos, int zc0, const float* cw, const float* cbias, int c0, float (&y)[8]) {
    const f32x4 b0 = *(const f32x4*)(cbias + c0), b1 = *(const f32x4*)(cbias + c0 + 4);
#pragma unroll
    for (int i = 0; i < 4; ++i) { y[i] = b0[i]; y[4 + i] = b1[i]; }
#pragma unroll
    for (int j = 0; j < 4; ++j) {
        if (pos - 3 + j >= 0) {
            const h16x8 xv = ld_h8(Z + (tok - 3 + j) * NZ + zc0);
            const f32x4 w0 = *(const f32x4*)(cw + j * 512 + c0), w1 = *(const f32x4*)(cw + j * 512 + c0 + 4);
#pragma unroll
            for (int i = 0; i < 4; ++i) { y[i] += w0[i] * (float)xv[i]; y[4 + i] += w1[i] * (float)xv[4 + i]; }
        }
    }
#pragma unroll
    for (int i = 0; i < 8; ++i) y[i] = siluf_(y[i]);
}

DI void mlstm_a_unit(LAS unsigned char* lds, const Args& a, int l, int item) {
    const int tid = launder(threadIdx.x), lane = tid & 63, wave = __builtin_amdgcn_readfirstlane(tid >> 6), r32 = lane & 31, hf = lane >> 5;
    const int T0 = item * 128, b = item >> 6, n = item & 63;
    const h16* Z = (const h16*)(a.ws + WS_R1); const h16* XH = (const h16*)(a.ws + WS_XH); const h16* WG = (const h16*)(a.ws + WS_WG16);
    const float* cw = a.conv_w + (size_t)l * 4 * 512; const float* cbias = a.conv_b + l * 512; const float* gb = a.gate_b + l * 8;
    float* CLOC = (float*)(a.ws + WS_CLOC); float* NLOC = (float*)(a.ws + WS_NLOC); float* GM = (float*)(a.ws + WS_GM); float* BL = (float*)(a.ws + WS_BL);
    float* BCUM = (float*)(a.ws + WS_BCUM); float* AVAL = (float*)(a.ws + WS_AVAL); float* AMAXP = (float*)(a.ws + WS_AMAXP);
    constexpr int PITCH = 272, KT_OFF = 0, VT_OFF = 2 * 64 * PITCH, G_OFF = 4 * 64 * PITCH;
    LAS float* gI = (LAS float*)(lds + G_OFF); LAS float* gF = gI + 512; LAS float* wS = gF + 512;
    __syncthreads();
    {
        f32x4 acc = {0.f, 0.f, 0.f, 0.f}; const int fr = lane & 15, fq = lane >> 4;
        const h16* ap = WG + fr * 1024 + 8 * fq; const h16* bp = XH + (size_t)(T0 + 16 * wave + fr) * D + 8 * fq;
#pragma unroll 8
        for (int k0 = 0; k0 < 1024; k0 += 32) acc = __builtin_amdgcn_mfma_f32_16x16x32_f16(ld_h8(ap + k0), ld_h8(bp + k0), acc, 0, 0, 0);
        const int t = 16 * wave + fr;
        if (fq == 0) {
#pragma unroll
            for (int j = 0; j < 4; ++j) gI[t * 4 + j] = acc[j] + gb[j];
        } else if (fq == 1) {
#pragma unroll
            for (int j = 0; j < 4; ++j) gF[t * 4 + j] = acc[j] + gb[4 + j];
        }
    }
    __syncthreads();
    if (wave < 4) {
        const int h = wave;
        const float ls0 = logsigf_(gF[(2 * lane) * 4 + h]), ls1 = logsigf_(gF[(2 * lane + 1) * 4 + h]);
        const float i0 = gI[(2 * lane) * 4 + h], i1 = gI[(2 * lane + 1) * 4 + h];
        const float ps = ls0 + ls1; float inc = ps;
#pragma unroll
        for (int o = 1; o < 64; o <<= 1) { const float t = __shfl_up(inc, o); if (lane >= o) inc += t; }
        const float exc = inc - ps, b0 = exc + ls0, b1 = inc;
        const float a0 = i0 - b0, a1 = i1 - b1; const float pm = fmaxf(a0, a1); float incm = pm;
#pragma unroll
        for (int o = 1; o < 64; o <<= 1) { const float t = __shfl_up(incm, o); if (lane >= o) incm = fmaxf(incm, t); }
        float excm = __shfl_up(incm, 1); if (lane == 0) excm = -INFINITY;
        const float blast = __shfl(inc, 63), amax = __shfl(incm, 63);
        wS[h * 128 + 2 * lane] = fexp(a0 - amax); wS[h * 128 + 2 * lane + 1] = fexp(a1 - amax);
        const size_t t0 = (size_t)(T0 + 2 * lane) * 4 + h;
        BCUM[t0] = b0; BCUM[t0 + 4] = b1; AVAL[t0] = a0; AVAL[t0 + 4] = a1; AMAXP[t0] = fmaxf(excm, a0); AMAXP[t0 + 4] = incm;
        if (lane == 0) { GM[(b * 4 + h) * 64 + n] = blast + amax; BL[(b * 4 + h) * 64 + n] = blast; }
    }
    __syncthreads();
    for (int pass = 0; pass < 2; ++pass) {
#pragma unroll 1
        for (int i = 0; i < 4; ++i) {
            const int idx = tid + 512 * i, s = idx & 127, chn = (idx >> 7) & 7, hh = idx >> 10, h = 2 * pass + hh;
            const int c0 = h * 64 + 8 * chn; const size_t tok = T0 + s; const int pos = 128 * n + s;
            float y[8]; conv8(Z, tok, pos, C_DK + c0, cw, cbias, 256 + c0, y);
#pragma unroll
            for (int e = 0; e < 8; ++e) *(LAS h16*)(lds + KT_OFF + (hh * 64 + 8 * chn + e) * PITCH + s * 2) = (h16)(y[e] * 0.125f);
            const h16x8 vv = ld_h8(Z + tok * NZ + C_DV + c0); const float w = wS[h * 128 + s];
#pragma unroll
            for (int e = 0; e < 8; ++e) *(LAS h16*)(lds + VT_OFF + (hh * 64 + 8 * chn + e) * PITCH + s * 2) = (h16)((float)vv[e] * w);
        }
        __syncthreads();
        {
            const int hh = wave >> 2, dt = (wave >> 1) & 1, et = wave & 1, h = 2 * pass + hh;
            f32x16 acc;
#pragma unroll
            for (int i = 0; i < 16; ++i) acc[i] = 0.f;
#pragma unroll
            for (int s0 = 0; s0 < 128; s0 += 16) {
                const h16x8 af = *(const LAS h16x8*)(lds + VT_OFF + (hh * 64 + 32 * dt + r32) * PITCH + (s0 + 8 * hf) * 2);
                const h16x8 bf = *(const LAS h16x8*)(lds + KT_OFF + (hh * 64 + 32 * et + r32) * PITCH + (s0 + 8 * hf) * 2);
                acc = __builtin_amdgcn_mfma_f32_32x32x16_f16(af, bf, acc, 0, 0, 0);
            }
            float* cl = CLOC + ((size_t)(b * 4 + h) * 64 + n) * 4096;
#pragma unroll
            for (int i = 0; i < 16; ++i) cl[(32 * dt + crow(i, hf)) * 64 + 32 * et + r32] = acc[i];
        }
        if (tid < 128) {
            const int hh = tid >> 6, e = tid & 63, h = 2 * pass + hh; float sacc = 0.f;
            for (int s = 0; s < 128; ++s) sacc += wS[h * 128 + s] * (float)*(const LAS h16*)(lds + KT_OFF + (hh * 64 + e) * PITCH + s * 2);
            NLOC[((size_t)(b * 4 + h) * 64 + n) * 64 + e] = sacc;
        }
        __syncthreads();
    }
}

DI void mlstm_c_unit(LAS unsigned char* lds, const Args& a, int l, int item) {
    const int tid = launder(threadIdx.x), lane = tid & 63, wave = __builtin_amdgcn_readfirstlane(tid >> 6), hw = wave >> 2, w4 = wave & 3, r32 = lane & 31, hf = lane >> 5;
    const int hp = item & 1, cn = item >> 1, b = cn >> 6, n = cn & 63, T0 = cn * 128;
    const int h = 2 * hp + hw, bh = b * 4 + h;
    const h16* Z = (const h16*)(a.ws + WS_R1); h16* MIX = (h16*)(a.ws + WS_MIX);
    const float* cw = a.conv_w + (size_t)l * 4 * 512; const float* cbias = a.conv_b + l * 512; const float* mg = a.mnorm_g + l * 64;
    const float* CLOC = (const float*)(a.ws + WS_CLOC); const float* NLOC = (const float*)(a.ws + WS_NLOC); const float* GM = (const float*)(a.ws + WS_GM); const float* BL = (const float*)(a.ws + WS_BL);
    const float* BCUM = (const float*)(a.ws + WS_BCUM); const float* AVAL = (const float*)(a.ws + WS_AVAL); const float* AMAXP = (const float*)(a.ws + WS_AMAXP);
    constexpr int K_OFF = 0, V_OFF = 32768, C_OFF = 65536, NP_OFF = 81920, TB_OFF = 82432;
    __syncthreads();
    float mprev = 0.f;
    {
        const int t8 = tid & 255; f32x4 c[4]; float nn = 0.f;
#pragma unroll
        for (int i = 0; i < 4; ++i) c[i] = (f32x4){0.f, 0.f, 0.f, 0.f};
        const float* cl = CLOC + (size_t)bh * 64 * 4096 + t8 * 4; const float* nl = NLOC + (size_t)bh * 64 * 64 + (t8 & 63);
        for (int j = 0; j < n; ++j) {
            const float gm = GM[bh * 64 + j], bl = BL[bh * 64 + j];
            const float mnew = fmaxf(bl + mprev, gm); const float fa = fexp(bl + mprev - mnew), fe = fexp(gm - mnew);
#pragma unroll
            for (int i = 0; i < 4; ++i) c[i] = c[i] * fa + *(const f32x4*)(cl + (size_t)j * 4096 + i * 1024) * fe;
            nn = nn * fa + nl[j * 64] * fe; mprev = mnew;
        }
#pragma unroll
        for (int i = 0; i < 4; ++i) { const int idx = (i * 256 + t8) * 4, d = idx >> 6, e = idx & 63;
            u32x2 w; w.x = pk_rne(c[i][0], c[i][1]); w.y = pk_rne(c[i][2], c[i][3]);
            *(LAS u32x2*)(lds + C_OFF + hw * 8192 + d * 128 + (((e >> 3) ^ ((d >> 1) & 7)) << 4) + (e & 7) * 2) = w; }
        if (t8 < 64) *(LAS float*)(lds + NP_OFF + hw * 256 + t8 * 4) = nn;
    }
#pragma unroll 1
    for (int i = 0; i < 4; ++i) {
        const int idx = tid + 512 * i, chn = idx & 7, s = (idx >> 3) & 127, hh = idx >> 10, hd = 2 * hp + hh;
        const int c0 = hd * 64 + 8 * chn; const size_t tok = T0 + s; const int pos = 128 * n + s;
        float y[8]; conv8(Z, tok, pos, C_DK + c0, cw, cbias, 256 + c0, y);
        u32x4 w; w.x = pk_rne(y[0] * 0.125f, y[1] * 0.125f); w.y = pk_rne(y[2] * 0.125f, y[3] * 0.125f); w.z = pk_rne(y[4] * 0.125f, y[5] * 0.125f); w.w = pk_rne(y[6] * 0.125f, y[7] * 0.125f);
        *(LAS u32x4*)(lds + K_OFF + hh * 16384 + koff(s, chn)) = w;
        *(LAS u32x4*)(lds + V_OFF + hh * 16384 + voff(s, chn)) = *(const u32x4*)(Z + tok * NZ + C_DV + c0);
    }
    for (int i = tid; i < 768; i += 512) { const int s = i & 127, k = (i >> 7) % 3, hh = i / 384; const size_t g = (size_t)(T0 + s) * 4 + 2 * hp + hh;
        *(LAS float*)(lds + TB_OFF + (hh * 3 + k) * 512 + s * 4) = k == 0 ? BCUM[g] : k == 1 ? AVAL[g] : AMAXP[g]; }
    const int t = 32 * w4 + r32; const size_t tokq = T0 + t;
    h16x8 qf[4];
#pragma unroll
    for (int ks = 0; ks < 4; ++ks) { const int c0 = h * 64 + 16 * ks + 8 * hf; float y[8]; conv8(Z, tokq, 128 * n + t, C_DQ + c0, cw, cbias, c0, y);
        u32x4 w; w.x = pk_rne(y[0], y[1]); w.y = pk_rne(y[2], y[3]); w.z = pk_rne(y[4], y[5]); w.w = pk_rne(y[6], y[7]); qf[ks] = __builtin_bit_cast(h16x8, w); }
    __syncthreads();
    const LAS unsigned char* Kt = lds + K_OFF + hw * 16384; const LAS unsigned char* Vt = lds + V_OFF + hw * 16384; const LAS unsigned char* Ct = lds + C_OFF + hw * 8192;
    const LAS float* TBb = (const LAS float*)(lds + TB_OFF + (hw * 3 + 0) * 512); const LAS float* TBa = TBb + 128; const LAS float* TBm = TBb + 256;
    const LAS float* NP = (const LAS float*)(lds + NP_OFF + hw * 256);
    const float Mt = fmaxf(mprev, TBm[t]), bt = TBb[t];
    f32x16 O[2]; float dpart = 0.f;
#pragma unroll
    for (int dt = 0; dt < 2; ++dt)
#pragma unroll
        for (int i = 0; i < 16; ++i) O[dt][i] = 0.f;
    for (int kb = 0; kb <= w4; ++kb) {
        f32x16 S[1]; qk_block<1>(S, Kt, 32 * kb, qf, r32, hf);
#pragma unroll
        for (int g = 0; g < 4; ++g) { const f32x4 av = *(const LAS f32x4*)(TBa + 32 * kb + 8 * g + 4 * hf);
#pragma unroll
            for (int j = 0; j < 4; ++j) { const int s = 32 * kb + 8 * g + 4 * hf + j; const float p = s <= t ? fexp(av[j] - Mt) * S[0][4 * g + j] : 0.f; S[0][4 * g + j] = p; dpart += p; } }
        pv_block(O, Vt, 32 * kb, S[0], lane);
    }
    f32x16 I[2];
#pragma unroll
    for (int dt = 0; dt < 2; ++dt) { f32x16 tmp[1]; qk_block<1>(tmp, Ct, 32 * dt, qf, r32, hf); I[dt] = tmp[0]; }
    float nq = 0.f;
#pragma unroll
    for (int ks = 0; ks < 4; ++ks) { const f32x4 n0 = *(const LAS f32x4*)(NP + 16 * ks + 8 * hf), n1 = *(const LAS f32x4*)(NP + 16 * ks + 8 * hf + 4);
#pragma unroll
        for (int i = 0; i < 4; ++i) nq += n0[i] * (float)qf[ks][i] + n1[i] * (float)qf[ks][4 + i]; }
    nq = xh_sum(nq);
    const float et = fexp(mprev - Mt);
    const float den = xh_sum(dpart) + et * nq;
    const float rden = 1.f / fmaxf(fabsf(den), fexp(-(bt + Mt)));
    float s1 = 0.f;
#pragma unroll
    for (int dt = 0; dt < 2; ++dt)
#pragma unroll
        for (int i = 0; i < 16; ++i) { const float hv = (O[dt][i] + et * I[dt][i]) * rden; O[dt][i] = hv; s1 += hv; }
    const float mean = xh_sum(s1) * (1.f / 64.f); float s2 = 0.f;
#pragma unroll
    for (int dt = 0; dt < 2; ++dt)
#pragma unroll
        for (int i = 0; i < 16; ++i) { const float dv = O[dt][i] - mean; O[dt][i] = dv; s2 += dv * dv; }
    const float rstd = 1.f / sqrtf(xh_sum(s2) * (1.f / 64.f) + LN_EPS);
#pragma unroll
    for (int dt = 0; dt < 2; ++dt)
#pragma unroll
        for (int g = 0; g < 4; ++g) { const int d = 32 * dt + 8 * g + 4 * hf; const f32x4 gg = *(const f32x4*)(mg + d);
            const h16x4 ov = ld_h4(Z + tokq * NZ + C_DO + h * 64 + d); float o[4];
#pragma unroll
            for (int i = 0; i < 4; ++i) o[i] = sigmoidf_((float)ov[i]) * (O[dt][4 * g + i] * rstd * gg[i]);
            u32x2 w; w.x = pk_rne(o[0], o[1]); w.y = pk_rne(o[2], o[3]); *(u32x2*)(MIX + tokq * D + 768 + h * 64 + d) = w; }
}

DI void dil_combine(const Args& a) {
    const h16* DILO = (const h16*)(a.ws + WS_DILO); const float* DILL = (const float*)(a.ws + WS_DILL); h16* MIX = (h16*)(a.ws + WS_MIX);
    const int gt = blockIdx.x * 512 + launder(threadIdx.x), NGT = gridDim.x * 512;
    for (int i = gt; i < M * 32; i += NGT) {
        const int tok = i >> 5, c8 = (i & 31) * 8, h = c8 >> 6;
        const float l0 = DILL[(size_t)tok * 4 + h], l1 = DILL[(size_t)(M + tok) * 4 + h], l2 = DILL[(size_t)(2 * M + tok) * 4 + h];
        const float mx = fmaxf(l0, fmaxf(l1, l2)); float w0 = ex2(l0 - mx), w1 = ex2(l1 - mx), w2 = ex2(l2 - mx); const float inv = 1.f / (w0 + w1 + w2); w0 *= inv; w1 *= inv; w2 *= inv;
        const h16x8 o0 = ld_h8(DILO + (size_t)tok * 256 + c8), o1 = ld_h8(DILO + (size_t)(M + tok) * 256 + c8), o2 = ld_h8(DILO + (size_t)(2 * M + tok) * 256 + c8);
        float o[8];
#pragma unroll
        for (int k = 0; k < 8; ++k) o[k] = w0 * (float)o0[k] + w1 * (float)o1[k] + w2 * (float)o2[k];
        u32x4 w; w.x = pk_rne(o[0], o[1]); w.y = pk_rne(o[2], o[3]); w.z = pk_rne(o[4], o[5]); w.w = pk_rne(o[6], o[7]);
        *(u32x4*)(MIX + (size_t)tok * D + 512 + c8) = w;
    }
}

DI void mixers_a(LAS unsigned char* lds, const Args& a, int l) {
    const h16* Z = (const h16*)(a.ws + WS_R1);
    const int G = gridDim.x, bx = blockIdx.x;
    float lam;
    {
        const float* lv = a.diff_lambda + l * 128; const int lane = launder(threadIdx.x) & 63;
        float p0 = lane < 32 ? lv[lane] * lv[32 + lane] : 0.f, p1 = lane < 32 ? lv[64 + lane] * lv[96 + lane] : 0.f;
        p0 = wave_sum(p0); p1 = wave_sum(p1);
        const float lam_init = 0.8f - 0.6f * expf(-0.3f * (float)l);
        lam = expf(p0) - expf(p1) + lam_init;
        AttnOut ao; ao.MIX = (h16*)(a.ws + WS_MIX); ao.subln_g = a.diff_subln_g + l * 64; ao.lam = lam; ao.one_m_lam_init = 1.f - lam_init; ao.DILO = nullptr; ao.DILL = nullptr;
        for (int pr = bx; pr < 256; pr += G) {
            const int bh = pr >> 5, q0 = pr & 31, b = bh >> 2, h = bh & 3;
#pragma unroll 1
            for (int k = 0; k < 2; ++k) {
                const int qb = k == 0 ? 63 - q0 : q0;
#ifndef SKIP_ATT0
                attn_unit<0>(lds, Z, b * SEQ + 128 * qb, 1, b * SEQ, 1, 0, qb, C_AQ + h * 64, C_AK + h * 64, C_AV + h * 64, qb, h, ao);
#endif
            }
        }
    }
    for (int u = bx; u < 1536; u += G) {
        const int p = u / 512, rem = u % 512, bh = rem >> 6, nr = rem & 63, b = bh >> 2, h = bh & 3;
        const int dl = p == 0 ? 1 : p == 1 ? 4 : 16; const int n = nr / dl, r = nr % dl;
        AttnOut ao; ao.MIX = nullptr; ao.subln_g = nullptr; ao.lam = 0.f; ao.one_m_lam_init = 0.f;
        ao.DILO = (h16*)(a.ws + WS_DILO) + (size_t)p * M * 256; ao.DILL = (float*)(a.ws + WS_DILL) + (size_t)p * M * 4;
        const int qtok0 = b * SEQ + 128 * n * dl + r, ktok0 = qtok0 - 128 * dl;
#ifndef SKIP_ATT1
        attn_unit<1>(lds, Z, qtok0, dl, ktok0, dl, n == 0 ? 1 : 0, 1, C_CQ + h * 64, C_CK + h * 64, C_CV + h * 64, 0, h, ao);
#endif
    }
    for (int u = bx; u < 256; u += G) {
#ifndef SKIP_SGU
        if (u < 128) sgu_unit(lds, a, l, u);
#endif
#ifndef SKIP_MA
        if (u >= 128) mlstm_a_unit(lds, a, l, u - 128);
#endif
    }
}

__global__ void __launch_bounds__(512, 2) hymba_fwd(Args a) {
    extern __shared__ __attribute__((aligned(16))) unsigned char lds_raw[];
    LAS unsigned char* lds = (LAS unsigned char*)lds_raw;
    cg::grid_group grid = cg::this_grid();
    const int G = gridDim.x, bx = blockIdx.x;
    h16* XH = (h16*)(a.ws + WS_XH); h16* MIX = (h16*)(a.ws + WS_MIX); h16* Zb = (h16*)(a.ws + WS_R1); float* Y = (float*)(a.ws + WS_R2);
    const h16* WIN = (const h16*)(a.ws + WS_WIN); const h16* WOUT = (const h16*)(a.ws + WS_WOUT); const h16* WGU = (const h16*)(a.ws + WS_WGU); const h16* WDN = (const h16*)(a.ws + WS_WDN);
    prologue(a, lds);
    grid.sync();
#pragma unroll 1
    for (int l = 0; l < DEPTH; ++l) {
        {
            pg8::Gemm g{XH, WIN, M, NZ, D}; pg8::StaticOrder S; S.init(M, NZ, G, bx);
            pg8::EpiZ E{Zb, (const float*)(a.ws + WS_ROPEA), (const float*)(a.ws + WS_ROPEC)};
#ifndef SKIP_G1
            pg8::gemm_phase<pg8::EpiZ, pg8::StaticOrder, true, true>(lds, g, S, E);
#endif
        }
        grid.sync();
        mixers_a(lds, a, l);
        grid.sync();
#ifndef SKIP_MC
        for (int u = bx; u < 256; u += G) mlstm_c_unit(lds, a, l, u);
#endif
        dil_combine(a);
        grid.sync();
        {
            pg8::Gemm g{MIX, WOUT, M, D, D}; pg8::StaticOrder S; S.init(M, D, G, bx);
            pg8::EpiRes E{l == 0 ? a.x : a.out, Y};
#ifndef SKIP_G3
            pg8::gemm_phase<pg8::EpiRes, pg8::StaticOrder, true, true>(lds, g, S, E);
#endif
        }
        grid.sync();
        ln_phase(Y, a.ln1_g + l * D, a.ln1_b + l * D, a.out, XH);
        grid.sync();
        {
            pg8::Gemm g{XH, WGU, M, NGU, D}; pg8::StaticOrder S; S.init(M, NGU, G, bx);
            pg8::EpiSwiglu E{Zb};
#ifndef SKIP_G4
            pg8::gemm_phase<pg8::EpiSwiglu, pg8::StaticOrder, true, true>(lds, g, S, E);
#endif
        }
        grid.sync();
        {
            pg8::Gemm g{Zb, WDN, M, D, DFF}; pg8::StaticOrder S; S.init(M, D, G, bx);
            pg8::EpiRes E{a.out, Y};
#ifndef SKIP_G5
            pg8::gemm_phase<pg8::EpiRes, pg8::StaticOrder, true, true>(lds, g, S, E);
#endif
        }
        grid.sync();
        ln_phase(Y, a.ln2_g + l * D, a.ln2_b + l * D, a.out, XH);
        if (l + 1 < DEPTH) convert_weights(a, l + 1, lds);
        grid.sync();
    }
}

extern "C" void kernel_launch(void* const* d_in, const int* in_sizes, int n_in, void* d_out, int out_size, void* d_ws, size_t ws_size, hipStream_t stream) {
    static int grid = 0;
    if (grid == 0) {
        if (n_in != 20 || ws_size < WS_END) { fprintf(stderr, "kernel_launch: unexpected inputs (n_in %d, ws %zu)\n", n_in, ws_size); grid = -1; return; }
        int dev = 0, cus = 0, per_cu = 0;
        hipGetDevice(&dev); hipDeviceGetAttribute(&cus, hipDeviceAttributeMultiprocessorCount, dev);
        hipFuncSetAttribute((const void*)hymba_fwd, hipFuncAttributeMaxDynamicSharedMemorySize, LDS_BYTES);
        hipOccupancyMaxActiveBlocksPerMultiprocessor(&per_cu, (const void*)hymba_fwd, 512, LDS_BYTES);
        if (per_cu < 1) { fprintf(stderr, "kernel_launch: occupancy query says %d blocks/CU\n", per_cu); per_cu = 1; }
        (void)hipGetLastError();
        grid = cus;
    }
    if (grid < 0) return;
    Args a{};
    const float** f = (const float**)&a;
    for (int i = 0; i < 20; ++i) f[i] = (const float*)d_in[i];
    a.out = (float*)d_out; a.ws = (unsigned char*)d_ws;
    void* args[] = {&a};
    hipError_t e = hipLaunchCooperativeKernel((const void*)hymba_fwd, dim3(grid), dim3(512), args, LDS_BYTES, stream);
    if (e != hipSuccess) fprintf(stderr, "cooperative launch failed: %s (grid %d)\n", hipGetErrorString(e), grid);
}
```
